# Optimizing an MI355X kernel written in HIP

```python
import math
import jax, jax.numpy as jnp
from jax import lax
import numpy as np

D_MODEL = 1024
BATCH = 8
SEQ = 2048
DEPTH = 2

CHUNK = 64
Q_BLOCK = 128
DIFF_HEADS = D_MODEL // 256
DIFF_HEAD_DIM = 64
DIFF_WIDTH = DIFF_HEADS * 2 * DIFF_HEAD_DIM
MLA_HEADS = D_MODEL // 256
MLA_NOPE_DIM = 128
MLA_ROPE_DIM = 64
MLA_V_DIM = 128
MLA_Q_RANK = D_MODEL // 4
MLA_KV_RANK = D_MODEL // 8
MLA_WIDTH = MLA_HEADS * MLA_V_DIM
MIX_WIDTH = DIFF_WIDTH + MLA_WIDTH
IN_WIDTH = 3 * DIFF_WIDTH + MLA_Q_RANK + MLA_KV_RANK + MLA_ROPE_DIM
D_FF = 4 * D_MODEL
N_BUCKETS = 32
MAX_DISTANCE = 128
ROPE_THETA = 10000.0
ALPHA = (2 * DEPTH) ** 0.25
BETA = (8 * DEPTH) ** -0.25
LN_EPS = 1e-5
RMS_EPS = 1e-6

kernel_name = "hybrid_diffattn_mla_deepnorm_encoder"


def _layer_norm(x, g, b):
    xf = x.astype(jnp.float32)
    mu = jnp.mean(xf, axis=-1, keepdims=True)
    var = jnp.mean(jnp.square(xf - mu), axis=-1, keepdims=True)
    y = (xf - mu) * lax.rsqrt(var + LN_EPS)
    return (y * g.astype(jnp.float32) + b.astype(jnp.float32)).astype(x.dtype)


def _rms_norm(x, g):
    xf = x.astype(jnp.float32)
    y = xf * lax.rsqrt(jnp.mean(jnp.square(xf), axis=-1, keepdims=True) + RMS_EPS)
    return (y * g.astype(jnp.float32)).astype(x.dtype)


def _t5_bucket(rel):
    nb = N_BUCKETS // 2
    ret = (rel > 0).astype(jnp.int32) * nb
    n = jnp.abs(rel)
    max_exact = nb // 2
    nf = jnp.maximum(n, 1).astype(jnp.float32)
    large = max_exact + (jnp.log(nf / max_exact) / math.log(MAX_DISTANCE / max_exact)
                         * (nb - max_exact)).astype(jnp.int32)
    large = jnp.minimum(large, nb - 1)
    return ret + jnp.where(n < max_exact, n, large)


def _chunk_mask(q_pos, k_pos):
    return (k_pos // CHUNK)[None, :] <= (q_pos // CHUNK)[:, None]


def _rope_tables(seq):
    pos = jnp.arange(seq, dtype=jnp.float32)
    inv = ROPE_THETA ** (-jnp.arange(0, MLA_ROPE_DIM, 2, dtype=jnp.float32) / MLA_ROPE_DIM)
    ang = pos[:, None] * inv[None, :]
    return jnp.cos(ang), jnp.sin(ang)


def _apply_rope(x, cos, sin):
    xf = x.astype(jnp.float32)
    x1, x2 = jnp.split(xf, 2, axis=-1)
    out = jnp.concatenate([x1 * cos - x2 * sin, x1 * sin + x2 * cos], axis=-1)
    return out.astype(x.dtype)


def _diff_attention(q, k, v, lam, rel_bias):
    S = q.shape[1]
    scale = DIFF_HEAD_DIM ** -0.5
    outs = []
    for i in range(S // Q_BLOCK):
        L = (i + 1) * Q_BLOCK
        q_pos = jnp.arange(i * Q_BLOCK, L)
        k_pos = jnp.arange(L)
        q_b = q[:, i * Q_BLOCK:L]
        logits = jnp.einsum('bqhmd,bkhmd->bhmqk', q_b, k[:, :L]).astype(jnp.float32) * scale
        bias = rel_bias[_t5_bucket(k_pos[None, :] - q_pos[:, None])]
        bias = jnp.transpose(bias, (2, 0, 1)).astype(jnp.float32)
        logits = logits + bias[None, :, None]
        mask = _chunk_mask(q_pos, k_pos)
        logits = jnp.where(mask[None, None, None], logits, -jnp.inf)
        p = jax.nn.softmax(logits, axis=-1)
        a = p[:, :, 0] - lam * p[:, :, 1]
        outs.append(jnp.einsum('bhqk,bkhe->bqhe', a.astype(v.dtype), v[:, :L]))
    return jnp.concatenate(outs, axis=1)


def _mla_attention(q_nope, q_rope, k_nope, k_rope, v):
    S = q_nope.shape[1]
    scale = (MLA_NOPE_DIM + MLA_ROPE_DIM) ** -0.5
    outs = []
    for i in range(S // Q_BLOCK):
        L = (i + 1) * Q_BLOCK
        q_pos = jnp.arange(i * Q_BLOCK, L)
        k_pos = jnp.arange(L)
        qs = slice(i * Q_BLOCK, L)
        logits = (jnp.einsum('bqhd,bkhd->bhqk', q_nope[:, qs], k_nope[:, :L]).astype(jnp.float32)
                  + jnp.einsum('bqhr,bkr->bhqk', q_rope[:, qs], k_rope[:, :L]).astype(jnp.float32)) * scale
        mask = _chunk_mask(q_pos, k_pos)
        logits = jnp.where(mask[None, None], logits, -jnp.inf)
        p = jax.nn.softmax(logits, axis=-1)
        outs.append(jnp.einsum('bhqk,bkhe->bqhe', p.astype(v.dtype), v[:, :L]))
    return jnp.concatenate(outs, axis=1)


def setup_inputs(seed: int = 0) -> dict:
    key = jax.random.key(seed)
    ks = jax.random.split(key, 20)
    f32 = jnp.float32

    def nrm(k, shape, std):
        return jax.random.normal(k, shape, f32) * std

    x = jax.random.normal(ks[0], (BATCH, SEQ, D_MODEL), f32)
    w_in = nrm(ks[1], (DEPTH, D_MODEL, IN_WIDTH), D_MODEL ** -0.5)
    col_scale = jnp.ones((IN_WIDTH,), f32).at[2 * DIFF_WIDTH:3 * DIFF_WIDTH].set(BETA)
    w_in = w_in * col_scale
    lambda_q1 = nrm(ks[2], (DEPTH, DIFF_HEAD_DIM), 0.1)
    lambda_k1 = nrm(ks[3], (DEPTH, DIFF_HEAD_DIM), 0.1)
    lambda_q2 = nrm(ks[4], (DEPTH, DIFF_HEAD_DIM), 0.1)
    lambda_k2 = nrm(ks[5], (DEPTH, DIFF_HEAD_DIM), 0.1)
    subln_g = 1.0 + nrm(ks[6], (DEPTH, 2 * DIFF_HEAD_DIM), 0.02)
    q_norm_g = 1.0 + nrm(ks[7], (DEPTH, MLA_Q_RANK), 0.02)
    w_uq = nrm(ks[8], (DEPTH, MLA_Q_RANK, MLA_HEADS * (MLA_NOPE_DIM + MLA_ROPE_DIM)), MLA_Q_RANK ** -0.5)
    kv_norm_g = 1.0 + nrm(ks[9], (DEPTH, MLA_KV_RANK), 0.02)
    w_ukv = nrm(ks[10], (DEPTH, MLA_KV_RANK, MLA_HEADS, MLA_NOPE_DIM + MLA_V_DIM), MLA_KV_RANK ** -0.5)
    v_scale = jnp.concatenate([jnp.ones((MLA_NOPE_DIM,), f32), jnp.full((MLA_V_DIM,), BETA, f32)])
    w_ukv = (w_ukv * v_scale).reshape(DEPTH, MLA_KV_RANK, MLA_HEADS * (MLA_NOPE_DIM + MLA_V_DIM))
    rel_bias = nrm(ks[11], (N_BUCKETS, DIFF_HEADS), 0.5)
    w_o = nrm(ks[12], (DEPTH, MIX_WIDTH, D_MODEL), MIX_WIDTH ** -0.5 * BETA)
    ln1_g = 1.0 + nrm(ks[13], (DEPTH, D_MODEL), 0.02)
    ln1_b = nrm(ks[14], (DEPTH, D_MODEL), 0.02)
    w_mlp_in = nrm(ks[15], (DEPTH, D_MODEL, D_FF), D_MODEL ** -0.5 * BETA)
    w_mlp_out = nrm(ks[16], (DEPTH, D_FF, D_MODEL), D_FF ** -0.5 * BETA)
    ln2_g = 1.0 + nrm(ks[17], (DEPTH, D_MODEL), 0.02)
    ln2_b = nrm(ks[18], (DEPTH, D_MODEL), 0.02)
    return {"x": x, "w_in": w_in, "lambda_q1": lambda_q1, "lambda_k1": lambda_k1,
            "lambda_q2": lambda_q2, "lambda_k2": lambda_k2, "subln_g": subln_g,
            "q_norm_g": q_norm_g, "w_uq": w_uq, "kv_norm_g": kv_norm_g, "w_ukv": w_ukv,
            "rel_bias": rel_bias, "w_o": w_o, "ln1_g": ln1_g, "ln1_b": ln1_b,
            "w_mlp_in": w_mlp_in, "w_mlp_out": w_mlp_out, "ln2_g": ln2_g, "ln2_b": ln2_b}


def reference(x, w_in, lambda_q1, lambda_k1, lambda_q2, lambda_k2, subln_g,
              q_norm_g, w_uq, kv_norm_g, w_ukv, rel_bias, w_o, ln1_g, ln1_b,
              w_mlp_in, w_mlp_out, ln2_g, ln2_b):
    B, S, _ = x.shape
    cos, sin = _rope_tables(S)
    o_q = DIFF_WIDTH
    o_k = 2 * DIFF_WIDTH
    o_cq = 3 * DIFF_WIDTH
    o_ckv = o_cq + MLA_Q_RANK
    o_kr = o_ckv + MLA_KV_RANK
    for l in range(DEPTH):
        lambda_init = 0.8 - 0.6 * math.exp(-0.3 * l)
        h = jnp.einsum('bsd,de->bse', x, w_in[l])

        dq = h[..., :o_q].reshape(B, S, DIFF_HEADS, 2, DIFF_HEAD_DIM)
        dk = h[..., o_q:o_k].reshape(B, S, DIFF_HEADS, 2, DIFF_HEAD_DIM)
        dv = h[..., o_k:o_cq].reshape(B, S, DIFF_HEADS, 2 * DIFF_HEAD_DIM)
        lam = (jnp.exp(jnp.sum(lambda_q1[l].astype(jnp.float32) * lambda_k1[l].astype(jnp.float32)))
               - jnp.exp(jnp.sum(lambda_q2[l].astype(jnp.float32) * lambda_k2[l].astype(jnp.float32)))
               + lambda_init)
        a_out = _diff_attention(dq, dk, dv, lam, rel_bias)
        a_out = _rms_norm(a_out, subln_g[l]) * (1.0 - lambda_init)

        c_q = _rms_norm(h[..., o_cq:o_ckv], q_norm_g[l])
        c_kv = _rms_norm(h[..., o_ckv:o_kr], kv_norm_g[l])
        k_rope = _apply_rope(h[..., o_kr:], cos, sin)
        qf = jnp.einsum('bsr,re->bse', c_q, w_uq[l]).reshape(B, S, MLA_HEADS, MLA_NOPE_DIM + MLA_ROPE_DIM)
        q_nope = qf[..., :MLA_NOPE_DIM]
        q_rope = _apply_rope(qf[..., MLA_NOPE_DIM:], cos[:, None, :], sin[:, None, :])
        kvf = jnp.einsum('bsr,re->bse', c_kv, w_ukv[l]).reshape(B, S, MLA_HEADS, MLA_NOPE_DIM + MLA_V_DIM)
        k_nope = kvf[..., :MLA_NOPE_DIM]
        mv = kvf[..., MLA_NOPE_DIM:]
        b_out = _mla_attention(q_nope, q_rope, k_nope, k_rope, mv)

        mix = jnp.concatenate([a_out.reshape(B, S, DIFF_WIDTH), b_out.reshape(B, S, MLA_WIDTH)], axis=-1)
        y = jnp.einsum('bse,ed->bsd', mix, w_o[l])
        x = _layer_norm(ALPHA * x + y, ln1_g[l], ln1_b[l])

        u = jnp.square(jax.nn.relu(jnp.einsum('bsd,df->bsf', x, w_mlp_in[l])))
        y = jnp.einsum('bsf,fd->bsd', u, w_mlp_out[l])
        x = _layer_norm(ALPHA * x + y, ln2_g[l], ln2_b[l])
    return x
```

```cpp
#include <hip/hip_runtime.h>
#include <cstdint>
#include <cstdio>

typedef unsigned short bf16_t;
typedef short bf16x8 __attribute__((ext_vector_type(8)));
typedef float f32x4 __attribute__((ext_vector_type(4)));
typedef unsigned u32x2 __attribute__((ext_vector_type(2)));

constexpr int BATCH = 8, SEQ = 2048, DM = 1024, M = BATCH * SEQ, DEPTH = 2;
constexpr int NIN = 1984, NINP = 2048, FF = 4096;
constexpr int QRANK = 256, KVRANK = 128, NUQ = 768, NUKV = 1024;
constexpr float LOG2E = 1.4426950408889634f;
constexpr float C2D = 0.125f * LOG2E;
constexpr float C2M = 0.07216878364870322f * LOG2E;
constexpr float ALPHA = 1.4142135623730951f;
constexpr float LN_EPS = 1e-5f, RMS_EPS = 1e-6f;

constexpr size_t MiB = 1u << 20;
constexpr size_t WS_W = 1 * MiB;
constexpr size_t WL_IN = 0, WL_UQ = 4 * MiB, WL_UKV = WL_UQ + 384 * 1024, WL_O = WL_UKV + 256 * 1024, WL_1 = WL_O + 2 * MiB, WL_2 = WL_1 + 8 * MiB, WL_STRIDE = 23 * MiB;
constexpr size_t WS_TAB = 47 * MiB;
constexpr size_t WS_XB = 48 * MiB;
constexpr size_t WS_MIX = 80 * MiB;
constexpr size_t WS_H = 112 * MiB;
constexpr size_t WS_QM = 176 * MiB;
constexpr size_t WS_KM = 200 * MiB;
constexpr size_t WS_VM = 224 * MiB;
constexpr size_t WS_U = 112 * MiB;
constexpr size_t WS_RSTD = 240 * MiB;
constexpr size_t WS_END = 256 * MiB;

__device__ __forceinline__ unsigned f2bf(float f) { unsigned u = __builtin_bit_cast(unsigned, f); return (u + 0x7fffu + ((u >> 16) & 1u)) >> 16; }
__device__ __forceinline__ float bf2f(unsigned h) { return __builtin_bit_cast(float, h << 16); }
__device__ __forceinline__ unsigned pk2(float lo, float hi) { return f2bf(lo) | (f2bf(hi) << 16); }
__device__ __forceinline__ float wave_sum(float v) {
#pragma unroll
    for (int o = 1; o < 64; o <<= 1) v += __shfl_xor(v, o);
    return v;
}
__device__ __forceinline__ float wave_max(float v) {
#pragma unroll
    for (int o = 1; o < 64; o <<= 1) v = fmaxf(v, __shfl_xor(v, o));
    return v;
}
__device__ __forceinline__ int t5_bucket(int rel) {
    const int ret = rel > 0 ? 16 : 0; const int n = rel < 0 ? -rel : rel;
    int v;
    if (n < 8) v = n; else { const int l2 = 31 - __clz(n * n); const int large = 8 + (l2 - 6); v = large < 15 ? large : 15; }
    return ret + v;
}

__device__ __forceinline__ int srccol(int n, int mode) {
    if (mode == 1) { if (n >= NIN) return -1; if (n >= 1920) { const int j = n - 1920; return 1920 + ((j & 1) ? 32 + (j >> 1) : (j >> 1)); } return n; }
    if (mode == 2) { const int hh = n / 192, w = n % 192; if (w >= 128) { const int j = w - 128; return hh * 192 + 128 + ((j & 1) ? 32 + (j >> 1) : (j >> 1)); } return n; }
    return n;
}
__global__ void __launch_bounds__(256) k_wconv(const float* W, int K, int N, int NP, const float* scale, int mode, bf16_t* WT) {
    __shared__ float t[64][33];
    const int nb = blockIdx.x, kb = blockIdx.y, n0 = nb * 32, k0 = kb * 64;
    const int tx = threadIdx.x & 31, ty = threadIdx.x >> 5;
    const int sc = srccol(n0 + tx, mode);
    for (int kk = ty; kk < 64; kk += 8) { const float s = scale ? scale[k0 + kk] : 1.f; t[kk][tx] = sc >= 0 ? s * W[(size_t)(k0 + kk) * N + sc] : 0.f; }
    __syncthreads();
    const int n = threadIdx.x >> 3, c = threadIdx.x & 7;
    uint4 o; o.x = pk2(t[8 * c + 0][n], t[8 * c + 1][n]); o.y = pk2(t[8 * c + 2][n], t[8 * c + 3][n]); o.z = pk2(t[8 * c + 4][n], t[8 * c + 5][n]); o.w = pk2(t[8 * c + 6][n], t[8 * c + 7][n]);
    *(uint4*)(WT + (size_t)(n0 + n) * K + k0 + 8 * c) = o;
}
__global__ void k_tables(float* cs) {
    const int i = blockIdx.x * blockDim.x + threadIdx.x; if (i >= SEQ * 32) return;
    const int pos = i >> 5, j = i & 31;
    const float inv = powf(10000.0f, -(float)j / 32.0f);
    const float ang = (float)pos * inv;
    cs[i] = cosf(ang); cs[SEQ * 32 + i] = sinf(ang);
}
__global__ void k_x2bf(const float* x, bf16_t* xb, int n4) {
    const int i = blockIdx.x * blockDim.x + threadIdx.x; if (i >= n4) return;
    const f32x4 v = ((const f32x4*)x)[i]; u32x2 o; o.x = pk2(v.x, v.y); o.y = pk2(v.z, v.w); ((u32x2*)xb)[i] = o;
}

template <class Epi>
__global__ void __launch_bounds__(256) gemm_naive(const bf16_t* A, int lda, const bf16_t* Bt, int K, Epi E) {
    const int wave = threadIdx.x >> 6, lane = threadIdx.x & 63, fr = lane & 15, fq = lane >> 4;
    const int row0 = blockIdx.y * 128 + (wave >> 1) * 64, col0 = blockIdx.x * 128 + (wave & 1) * 64;
    f32x4 acc[4][4];
#pragma unroll
    for (int i = 0; i < 4; ++i)
#pragma unroll
        for (int j = 0; j < 4; ++j) acc[i][j] = (f32x4){0.f, 0.f, 0.f, 0.f};
    for (int k0 = 0; k0 < K; k0 += 32) {
        bf16x8 a[4], b[4];
#pragma unroll
        for (int i = 0; i < 4; ++i) a[i] = *(const bf16x8*)(A + (size_t)(row0 + 16 * i + fr) * lda + k0 + 8 * fq);
#pragma unroll
        for (int j = 0; j < 4; ++j) b[j] = *(const bf16x8*)(Bt + (size_t)(col0 + 16 * j + fr) * K + k0 + 8 * fq);
#pragma unroll
        for (int i = 0; i < 4; ++i)
#pragma unroll
            for (int j = 0; j < 4; ++j) acc[i][j] = __builtin_amdgcn_mfma_f32_16x16x32_bf16(b[j], a[i], acc[i][j], 0, 0, 0);
    }
#pragma unroll
    for (int i = 0; i < 4; ++i)
#pragma unroll
        for (int j = 0; j < 4; ++j) E(row0 + 16 * i + fr, col0 + 16 * j + 4 * fq, acc[i][j]);
}
__device__ __forceinline__ void st_bf4(bf16_t* p, f32x4 v) { u32x2 o; o.x = pk2(v.x, v.y); o.y = pk2(v.z, v.w); *(u32x2*)p = o; }

struct EpiInproj {
    bf16_t* H; const float* cs;
    __device__ __forceinline__ void operator()(int row, int col, f32x4 v) const {
        if (col < 512) v = v * C2D;
        else if (col >= 1920 && col < 1984) {
            const int pos = row & (SEQ - 1), j = (col - 1920) >> 1;
            const float c0 = cs[pos * 32 + j], s0 = cs[SEQ * 32 + pos * 32 + j], c1 = cs[pos * 32 + j + 1], s1 = cs[SEQ * 32 + pos * 32 + j + 1];
            v = (f32x4){v.x * c0 - v.y * s0, v.x * s0 + v.y * c0, v.z * c1 - v.w * s1, v.z * s1 + v.w * c1};
        }
        st_bf4(H + (size_t)row * NINP + col, v);
    }
};
struct EpiUq {
    bf16_t* Q; const float* rstd; const float* cs;
    __device__ __forceinline__ void operator()(int row, int col, f32x4 v) const {
        v = v * rstd[row * 2];
        const int w = col % 192;
        if (w >= 128) {
            const int pos = row & (SEQ - 1), j = (w - 128) >> 1;
            const float c0 = cs[pos * 32 + j], s0 = cs[SEQ * 32 + pos * 32 + j], c1 = cs[pos * 32 + j + 1], s1 = cs[SEQ * 32 + pos * 32 + j + 1];
            v = (f32x4){v.x * c0 - v.y * s0, v.x * s0 + v.y * c0, v.z * c1 - v.w * s1, v.z * s1 + v.w * c1};
        }
        st_bf4(Q + (size_t)row * NUQ + col, v * C2M);
    }
};
struct EpiUkv {
    bf16_t* Kb; bf16_t* Vb; const float* rstd;
    __device__ __forceinline__ void operator()(int row, int col, f32x4 v) const {
        v = v * rstd[row * 2 + 1];
        const int hh = col >> 8, w = col & 255;
        if (w < 128) st_bf4(Kb + (size_t)row * 768 + hh * 192 + w, v); else st_bf4(Vb + (size_t)row * 512 + hh * 128 + (w - 128), v);
    }
};
struct EpiResid {
    const float* base; float* out;
    __device__ __forceinline__ void operator()(int row, int col, f32x4 v) const {
        const f32x4 b = *(const f32x4*)(base + (size_t)row * DM + col);
        *(f32x4*)(out + (size_t)row * DM + col) = b * ALPHA + v;
    }
};
struct EpiRelu2 {
    bf16_t* U;
    __device__ __forceinline__ void operator()(int row, int col, f32x4 v) const {
        f32x4 r; r.x = v.x > 0.f ? v.x * v.x : 0.f; r.y = v.y > 0.f ? v.y * v.y : 0.f; r.z = v.z > 0.f ? v.z * v.z : 0.f; r.w = v.w > 0.f ? v.w * v.w : 0.f;
        st_bf4(U + (size_t)row * FF + col, r);
    }
};

__global__ void __launch_bounds__(256) k_rowstat(const bf16_t* H, float* rstd, bf16_t* Kb) {
    const int row = blockIdx.x * 4 + (threadIdx.x >> 6), lane = threadIdx.x & 63;
    const bf16_t* h = H + (size_t)row * NINP;
    const u32x2 q = *(const u32x2*)(h + 1536 + 4 * lane);
    const float q0 = bf2f(q.x & 0xffff), q1 = bf2f(q.x >> 16), q2 = bf2f(q.y & 0xffff), q3 = bf2f(q.y >> 16);
    const float sq = wave_sum(q0 * q0 + q1 * q1 + q2 * q2 + q3 * q3);
    const unsigned kv = *(const unsigned*)(h + 1792 + 2 * lane);
    const float k0 = bf2f(kv & 0xffff), k1 = bf2f(kv >> 16);
    const float sk = wave_sum(k0 * k0 + k1 * k1);
    if (lane == 0) { rstd[row * 2] = rsqrtf(sq * (1.f / 256.f) + RMS_EPS); rstd[row * 2 + 1] = rsqrtf(sk * (1.f / 128.f) + RMS_EPS); }
    const bf16_t kr = h[1920 + lane];
#pragma unroll
    for (int hh = 0; hh < 4; ++hh) Kb[(size_t)row * 768 + hh * 192 + 128 + lane] = kr;
}
__global__ void __launch_bounds__(256) k_ln(float* X, const float* g, const float* b, bf16_t* Xb) {
    const int row = blockIdx.x * 4 + (threadIdx.x >> 6), lane = threadIdx.x & 63;
    f32x4* xr = (f32x4*)(X + (size_t)row * DM) + lane;
    f32x4 v[4]; float s = 0.f;
#pragma unroll
    for (int j = 0; j < 4; ++j) { v[j] = xr[64 * j]; s += (v[j].x + v[j].y) + (v[j].z + v[j].w); }
    const float mean = wave_sum(s) * (1.f / DM); float s2 = 0.f;
#pragma unroll
    for (int j = 0; j < 4; ++j) { v[j] = v[j] - mean; s2 += (v[j].x * v[j].x + v[j].y * v[j].y) + (v[j].z * v[j].z + v[j].w * v[j].w); }
    const float rs = rsqrtf(wave_sum(s2) * (1.f / DM) + LN_EPS);
#pragma unroll
    for (int j = 0; j < 4; ++j) {
        const f32x4 gg = ((const f32x4*)g)[lane + 64 * j], bb = ((const f32x4*)b)[lane + 64 * j];
        const f32x4 o = v[j] * rs * gg + bb; xr[64 * j] = o;
        u32x2 w; w.x = pk2(o.x, o.y); w.y = pk2(o.z, o.w); ((u32x2*)(Xb + (size_t)row * DM))[lane + 64 * j] = w;
    }
}

__device__ __forceinline__ float dot8(const bf16_t* a, const bf16_t* b) {
    const uint4 x = *(const uint4*)a, y = *(const uint4*)b;
    float s = bf2f(x.x & 0xffff) * bf2f(y.x & 0xffff) + bf2f(x.x >> 16) * bf2f(y.x >> 16);
    s += bf2f(x.y & 0xffff) * bf2f(y.y & 0xffff) + bf2f(x.y >> 16) * bf2f(y.y >> 16);
    s += bf2f(x.z & 0xffff) * bf2f(y.z & 0xffff) + bf2f(x.z >> 16) * bf2f(y.z >> 16);
    s += bf2f(x.w & 0xffff) * bf2f(y.w & 0xffff) + bf2f(x.w >> 16) * bf2f(y.w >> 16);
    return s;
}
__global__ void __launch_bounds__(256) attn_diff_naive(const bf16_t* H, const float* rel_bias, const float* lq1, const float* lk1, const float* lq2, const float* lk2,
                                                      float lambda_init, const float* subg, bf16_t* MIX) {
    __shared__ float sc[4][2][SEQ];
    const int wave = threadIdx.x >> 6, lane = threadIdx.x & 63;
    const int gid = blockIdx.x * 4 + wave;
    const int q = gid % SEQ, hd = (gid / SEQ) % 4, b = gid / (SEQ * 4);
    const size_t rowq = (size_t)b * SEQ + q;
    const int nk = 64 * (q / 64 + 1);
    const float lam = __expf(wave_sum(lq1[lane] * lk1[lane])) - __expf(wave_sum(lq2[lane] * lk2[lane])) + lambda_init;
    float* s0 = sc[wave][0]; float* s1 = sc[wave][1];
    const bf16_t* qp = H + rowq * NINP + hd * 128;
    float mx0 = -INFINITY, mx1 = -INFINITY;
    for (int k = lane; k < nk; k += 64) {
        const bf16_t* kp = H + ((size_t)b * SEQ + k) * NINP + 512 + hd * 128;
        float a0 = 0.f, a1 = 0.f;
#pragma unroll
        for (int d = 0; d < 64; d += 8) { a0 += dot8(qp + d, kp + d); a1 += dot8(qp + 64 + d, kp + 64 + d); }
        const float bias = rel_bias[t5_bucket(k - q) * 4 + hd] * LOG2E;
        a0 += bias; a1 += bias; s0[k] = a0; s1[k] = a1; mx0 = fmaxf(mx0, a0); mx1 = fmaxf(mx1, a1);
    }
    mx0 = wave_max(mx0); mx1 = wave_max(mx1);
    float l0 = 0.f, l1 = 0.f;
    for (int k = lane; k < nk; k += 64) { const float p0 = exp2f(s0[k] - mx0), p1 = exp2f(s1[k] - mx1); s0[k] = p0; s1[k] = p1; l0 += p0; l1 += p1; }
    l0 = wave_sum(l0); l1 = wave_sum(l1);
    const float i0 = 1.f / l0, i1 = lam / l1;
    for (int k = lane; k < nk; k += 64) s0[k] = s0[k] * i0 - s1[k] * i1;
    __syncthreads();
    const int e = 2 * lane; float o0 = 0.f, o1 = 0.f;
    const bf16_t* vp = H + (size_t)b * SEQ * NINP + 1024 + hd * 128 + e;
    for (int k = 0; k < nk; ++k) { const float a = s0[k]; const unsigned vv = *(const unsigned*)(vp + (size_t)k * NINP); o0 += a * bf2f(vv & 0xffff); o1 += a * bf2f(vv >> 16); }
    const float rs = rsqrtf(wave_sum(o0 * o0 + o1 * o1) * (1.f / 128.f) + RMS_EPS) * (1.f - lambda_init);
    *(unsigned*)(MIX + rowq * DM + hd * 128 + e) = pk2(o0 * rs * subg[e], o1 * rs * subg[e + 1]);
}
__global__ void __launch_bounds__(256) attn_mla_naive(const bf16_t* Qm, const bf16_t* Km, const bf16_t* Vm, bf16_t* MIX) {
    __shared__ float sc[4][SEQ];
    const int wave = threadIdx.x >> 6, lane = threadIdx.x & 63;
    const int gid = blockIdx.x * 4 + wave;
    const int q = gid % SEQ, hd = (gid / SEQ) % 4, b = gid / (SEQ * 4);
    const size_t rowq = (size_t)b * SEQ + q;
    const int nk = 64 * (q / 64 + 1);
    float* s0 = sc[wave];
    const bf16_t* qp = Qm + rowq * 768 + hd * 192;
    float mx0 = -INFINITY;
    for (int k = lane; k < nk; k += 64) {
        const bf16_t* kp = Km + ((size_t)b * SEQ + k) * 768 + hd * 192;
        float a0 = 0.f;
#pragma unroll
        for (int d = 0; d < 192; d += 8) a0 += dot8(qp + d, kp + d);
        s0[k] = a0; mx0 = fmaxf(mx0, a0);
    }
    mx0 = wave_max(mx0);
    float l0 = 0.f;
    for (int k = lane; k < nk; k += 64) { const float p0 = exp2f(s0[k] - mx0); s0[k] = p0; l0 += p0; }
    l0 = wave_sum(l0);
    __syncthreads();
    const int e = 2 * lane; float o0 = 0.f, o1 = 0.f;
    const bf16_t* vp = Vm + (size_t)b * SEQ * 512 + hd * 128 + e;
    for (int k = 0; k < nk; ++k) { const float a = s0[k]; const unsigned vv = *(const unsigned*)(vp + (size_t)k * 512); o0 += a * bf2f(vv & 0xffff); o1 += a * bf2f(vv >> 16); }
    const float il = 1.f / l0;
    *(unsigned*)(MIX + rowq * DM + 512 + hd * 128 + e) = pk2(o0 * il, o1 * il);
}

extern "C" void kernel_launch(void* const* d_in, const int* in_sizes, int n_in, void* d_out, int out_size, void* d_ws, size_t ws_size, hipStream_t stream) {
    if (n_in != 19 || ws_size < WS_END) { fprintf(stderr, "kernel_launch: unexpected n_in %d / ws %zu\n", n_in, ws_size); return; }
    const float* x = (const float*)d_in[0];
    const float* w_in = (const float*)d_in[1];
    const float* lq1 = (const float*)d_in[2]; const float* lk1 = (const float*)d_in[3]; const float* lq2 = (const float*)d_in[4]; const float* lk2 = (const float*)d_in[5];
    const float* subln_g = (const float*)d_in[6]; const float* q_norm_g = (const float*)d_in[7]; const float* w_uq = (const float*)d_in[8];
    const float* kv_norm_g = (const float*)d_in[9]; const float* w_ukv = (const float*)d_in[10]; const float* rel_bias = (const float*)d_in[11];
    const float* w_o = (const float*)d_in[12]; const float* ln1_g = (const float*)d_in[13]; const float* ln1_b = (const float*)d_in[14];
    const float* w1 = (const float*)d_in[15]; const float* w2 = (const float*)d_in[16]; const float* ln2_g = (const float*)d_in[17]; const float* ln2_b = (const float*)d_in[18];
    unsigned char* ws = (unsigned char*)d_ws; float* out = (float*)d_out;
    float* cs = (float*)(ws + WS_TAB); bf16_t* Xb = (bf16_t*)(ws + WS_XB); bf16_t* MIX = (bf16_t*)(ws + WS_MIX); bf16_t* H = (bf16_t*)(ws + WS_H);
    bf16_t* Qm = (bf16_t*)(ws + WS_QM); bf16_t* Km = (bf16_t*)(ws + WS_KM); bf16_t* Vm = (bf16_t*)(ws + WS_VM); bf16_t* U = (bf16_t*)(ws + WS_U); float* rstd = (float*)(ws + WS_RSTD);

    k_tables<<<SEQ * 32 / 256, 256, 0, stream>>>(cs);
    k_x2bf<<<M * DM / 4 / 256, 256, 0, stream>>>(x, Xb, M * DM / 4);
    for (int l = 0; l < DEPTH; ++l) {
        unsigned char* wl = ws + WS_W + l * WL_STRIDE;
        k_wconv<<<dim3(NINP / 32, DM / 64), 256, 0, stream>>>(w_in + (size_t)l * DM * NIN, DM, NIN, NINP, nullptr, 1, (bf16_t*)(wl + WL_IN));
        k_wconv<<<dim3(NUQ / 32, QRANK / 64), 256, 0, stream>>>(w_uq + (size_t)l * QRANK * NUQ, QRANK, NUQ, NUQ, q_norm_g + l * QRANK, 2, (bf16_t*)(wl + WL_UQ));
        k_wconv<<<dim3(NUKV / 32, KVRANK / 64), 256, 0, stream>>>(w_ukv + (size_t)l * KVRANK * NUKV, KVRANK, NUKV, NUKV, kv_norm_g + l * KVRANK, 0, (bf16_t*)(wl + WL_UKV));
        k_wconv<<<dim3(DM / 32, DM / 64), 256, 0, stream>>>(w_o + (size_t)l * DM * DM, DM, DM, DM, nullptr, 0, (bf16_t*)(wl + WL_O));
        k_wconv<<<dim3(FF / 32, DM / 64), 256, 0, stream>>>(w1 + (size_t)l * DM * FF, DM, FF, FF, nullptr, 0, (bf16_t*)(wl + WL_1));
        k_wconv<<<dim3(DM / 32, FF / 64), 256, 0, stream>>>(w2 + (size_t)l * FF * DM, FF, DM, DM, nullptr, 0, (bf16_t*)(wl + WL_2));
    }
    for (int l = 0; l < DEPTH; ++l) {
        unsigned char* wl = ws + WS_W + l * WL_STRIDE;
        const float lambda_init = (l == 0) ? 0.2f : (float)(0.8 - 0.6 * 0.7408182206817179);
        gemm_naive<EpiInproj><<<dim3(NINP / 128, M / 128), 256, 0, stream>>>(Xb, DM, (const bf16_t*)(wl + WL_IN), DM, EpiInproj{H, cs});
        k_rowstat<<<M / 4, 256, 0, stream>>>(H, rstd, Km);
        gemm_naive<EpiUq><<<dim3(NUQ / 128, M / 128), 256, 0, stream>>>(H + 1536, NINP, (const bf16_t*)(wl + WL_UQ), QRANK, EpiUq{Qm, rstd, cs});
        gemm_naive<EpiUkv><<<dim3(NUKV / 128, M / 128), 256, 0, stream>>>(H + 1792, NINP, (const bf16_t*)(wl + WL_UKV), KVRANK, EpiUkv{Km, Vm, rstd});
        attn_diff_naive<<<M * 4 / 4, 256, 0, stream>>>(H, rel_bias, lq1 + l * 64, lk1 + l * 64, lq2 + l * 64, lk2 + l * 64, lambda_init, subln_g + l * 128, MIX);
        attn_mla_naive<<<M * 4 / 4, 256, 0, stream>>>(Qm, Km, Vm, MIX);
        gemm_naive<EpiResid><<<dim3(DM / 128, M / 128), 256, 0, stream>>>(MIX, DM, (const bf16_t*)(wl + WL_O), DM, EpiResid{l == 0 ? x : out, out});
        k_ln<<<M / 4, 256, 0, stream>>>(out, ln1_g + l * DM, ln1_b + l * DM, Xb);
        gemm_naive<EpiRelu2><<<dim3(FF / 128, M / 128), 256, 0, stream>>>(Xb, DM, (const bf16_t*)(wl + WL_1), DM, EpiRelu2{U});
        gemm_naive<EpiResid><<<dim3(DM / 128, M / 128), 256, 0, stream>>>(U, FF, (const bf16_t*)(wl + WL_2), FF, EpiResid{out, out});
        k_ln<<<M / 4, 256, 0, stream>>>(out, ln2_g + l * DM, ln2_b + l * DM, Xb);
    }
}
```
